# Optimizing an MI355X kernel written in HIP

```python
import jax, jax.numpy as jnp
from jax import lax
import numpy as np

D_MODEL = 2048
BATCH = 2
SEQ = 4096
DEPTH = 2

HEAD_DIM = 64
A_HEADS = 8
A_WIDTH = A_HEADS * HEAD_DIM
CHUNK = 128
B_WIDTH = 768
CONV_WIDTH = 3
DILATION_PATTERNS = ((128, 1), (512, 4), (2048, 16))
C_HEADS_PER_PATTERN = 4
C_HEADS = C_HEADS_PER_PATTERN * len(DILATION_PATTERNS)
C_WIDTH = C_HEADS * HEAD_DIM
D_MIX = A_WIDTH + B_WIDTH + C_WIDTH
PROJ_SIZES = (A_WIDTH, A_WIDTH, B_WIDTH, B_WIDTH, B_WIDTH, C_WIDTH, C_WIDTH, C_WIDTH)
PROJ_SPLITS = tuple(int(s) for s in np.cumsum(PROJ_SIZES)[:-1])
D_IN_PROJ = sum(PROJ_SIZES)
D_FF = 4 * D_MODEL
EPS = 1e-6

kernel_name = 'hymba_style_sgu_shortconv_dilated_attn'


def rms_norm(x, g):
    x32 = x.astype(jnp.float32)
    y = x32 * lax.rsqrt(jnp.mean(x32 * x32, axis=-1, keepdims=True) + EPS)
    return (y * g.astype(jnp.float32)).astype(x.dtype)


def spatial_gating(u, v, w_s, b_s):
    bsz, s = u.shape[:2]
    n_chunks = s // CHUNK
    vc = v.reshape(bsz, n_chunks, CHUNK, A_HEADS, HEAD_DIM)
    w_causal = jnp.tril(w_s)
    mixed = jnp.einsum('hij,bcjhd->bcihd', w_causal, vc) + b_s.T[None, None, :, :, None]
    return u * mixed.reshape(bsz, s, A_WIDTH)


def short_gated_conv(b_gate, c_gate, xb, w_conv):
    z = c_gate * xb
    zp = jnp.pad(z, ((0, 0), (CONV_WIDTH - 1, 0), (0, 0)))
    s = z.shape[1]
    conv = sum(w_conv[i] * zp[:, i:i + s] for i in range(CONV_WIDTH))
    return b_gate * conv


def head_rms_norm(x, g):
    x32 = x.astype(jnp.float32)
    return x32 * lax.rsqrt(jnp.mean(x32 * x32, axis=-1, keepdims=True) + EPS) * g.astype(jnp.float32)


def dilated_window_attention(q, k, v, window, dilation):
    bsz, s, h, d = q.shape
    length = s // dilation
    blk = window // dilation
    nb = -(-length // blk)
    lp = nb * blk

    def to_sub(t):
        t = t.reshape(bsz, length, dilation, h, d).transpose(0, 2, 1, 3, 4)
        t = jnp.pad(t, ((0, 0), (0, 0), (0, lp - length), (0, 0), (0, 0)))
        return t.reshape(bsz, dilation, nb, blk, h, d)

    qb = to_sub(q)
    kb = to_sub(k)
    vb = to_sub(v.astype(jnp.float32))
    pad_prev = ((0, 0), (0, 0), (1, 0), (0, 0), (0, 0), (0, 0))
    kcat = jnp.concatenate([jnp.pad(kb, pad_prev)[:, :, :-1], kb], axis=3)
    vcat = jnp.concatenate([jnp.pad(vb, pad_prev)[:, :, :-1], vb], axis=3)

    scores = jnp.einsum('brnqhd,brnkhd->brnhqk', qb, kcat) * (HEAD_DIM ** -0.5)
    qi = jnp.arange(blk)[:, None]
    kj = jnp.arange(2 * blk)[None, :]
    band = (kj >= qi) & (kj <= qi + blk)
    has_prev = jnp.arange(nb)[:, None, None] > 0
    mask = band[None] & (has_prev | (kj >= blk)[None])
    scores = jnp.where(mask[None, None, :, None], scores, -jnp.inf)
    m = jnp.max(scores, axis=-1, keepdims=True)
    e = jnp.exp(scores - m)
    den = jnp.sum(e, axis=-1, keepdims=True)
    o = jnp.einsum('brnhqk,brnkhd->brnhqd', e, vcat) / den
    lse = (m + jnp.log(den))[..., 0]

    o = o.transpose(0, 1, 2, 4, 3, 5).reshape(bsz, dilation, lp, h, d)[:, :, :length]
    o = o.transpose(0, 2, 1, 3, 4).reshape(bsz, s, h, d)
    lse = lse.transpose(0, 1, 2, 4, 3).reshape(bsz, dilation, lp, h)[:, :, :length]
    lse = lse.transpose(0, 2, 1, 3).reshape(bsz, s, h)
    return o, lse


def dilated_mixture(q, k, v, q_g, k_g):
    bsz, s = q.shape[:2]
    q = head_rms_norm(q.reshape(bsz, s, C_HEADS, HEAD_DIM), q_g)
    k = head_rms_norm(k.reshape(bsz, s, C_HEADS, HEAD_DIM), k_g)
    v = v.reshape(bsz, s, C_HEADS, HEAD_DIM)
    outs, lses = [], []
    for g, (window, dilation) in enumerate(DILATION_PATTERNS):
        sl = slice(g * C_HEADS_PER_PATTERN, (g + 1) * C_HEADS_PER_PATTERN)
        o, lse = dilated_window_attention(q[:, :, sl], k[:, :, sl], v[:, :, sl], window, dilation)
        outs.append(o)
        lses.append(lse)
    alpha = jax.nn.softmax(jnp.stack(lses, axis=0), axis=0)
    y = jnp.stack(outs, axis=0) * alpha[..., None]
    return y.transpose(1, 2, 0, 3, 4).reshape(bsz, s, C_WIDTH).astype(v.dtype)


def setup_inputs(seed: int = 0) -> dict:
    key = jax.random.key(seed)
    ks = jax.random.split(key, 12)
    n = jax.random.normal
    f32 = jnp.float32
    return {
        'x': n(ks[0], (BATCH, SEQ, D_MODEL), f32),
        'attn_norm': 1.0 + 0.02 * n(ks[1], (DEPTH, D_MODEL), f32),
        'w_in': n(ks[2], (DEPTH, D_MODEL, D_IN_PROJ), f32) * D_MODEL ** -0.5,
        'sgu_w': n(ks[3], (DEPTH, A_HEADS, CHUNK, CHUNK), f32) * CHUNK ** -0.5,
        'sgu_b': 1.0 + 0.1 * n(ks[4], (DEPTH, A_HEADS, CHUNK), f32),
        'conv_w': n(ks[5], (DEPTH, CONV_WIDTH, B_WIDTH), f32) * CONV_WIDTH ** -0.5,
        'q_norm': 1.0 + 0.02 * n(ks[6], (DEPTH, HEAD_DIM), f32),
        'k_norm': 1.0 + 0.02 * n(ks[7], (DEPTH, HEAD_DIM), f32),
        'w_out': n(ks[8], (DEPTH, D_MIX, D_MODEL), f32) * D_MIX ** -0.5,
        'mlp_norm': 1.0 + 0.02 * n(ks[9], (DEPTH, D_MODEL), f32),
        'w_mlp_in': n(ks[10], (DEPTH, D_MODEL, D_FF), f32) * D_MODEL ** -0.5,
        'w_mlp_out': n(ks[11], (DEPTH, D_FF, D_MODEL), f32) * D_FF ** -0.5,
    }


def reference(x, attn_norm, w_in, sgu_w, sgu_b, conv_w, q_norm, k_norm, w_out,
              mlp_norm, w_mlp_in, w_mlp_out):
    for l in range(DEPTH):
        h = rms_norm(x, attn_norm[l])
        p = h @ w_in[l]
        a_u, a_v, b_b, b_c, b_x, q, k, v = jnp.split(p, PROJ_SPLITS, axis=-1)
        y_a = spatial_gating(a_u, a_v, sgu_w[l], sgu_b[l])
        y_b = short_gated_conv(b_b, b_c, b_x, conv_w[l])
        y_c = dilated_mixture(q, k, v, q_norm[l], k_norm[l])
        x = x + jnp.concatenate([y_a, y_b, y_c], axis=-1) @ w_out[l]
        h = rms_norm(x, mlp_norm[l])
        x = x + jnp.square(jax.nn.relu(h @ w_mlp_in[l])) @ w_mlp_out[l]
    return x
```

```cpp
#include <hip/hip_runtime.h>
#include <hip/hip_cooperative_groups.h>
#include <cstdio>
#include <cstdint>
namespace cg = cooperative_groups;
namespace pg8 {
#define PG8_LAS __attribute__((address_space(3)))
typedef unsigned short bf16_t;
typedef short bf16x8 __attribute__((ext_vector_type(8)));
typedef float f32x4 __attribute__((ext_vector_type(4)));
typedef unsigned u32x4 __attribute__((ext_vector_type(4)));
constexpr int BM = 256, BK = 64, HALF = 128, HTB = HALF * BK * 2  , STAGE_BYTES = 8 * HTB, NXCD = 8, WGM = 8;

__host__ __device__ __forceinline__ int lds_byte(int r, int c) { const int st = (r >> 4) * 2 + (c >> 5), rr = r & 15, cc = c & 31, ob = rr * 64 + cc * 2; return st * 1024 + (ob ^ (((ob >> 9) & 1) << 5)); }
__host__ __device__ __forceinline__ void stage_rc(int b, int& R, int& C) { const int st = b / 1024, sb = b % 1024, swz = sb ^ (((sb >> 9) & 1) << 5); R = (st >> 1) * 16 + swz / 64; C = (st & 1) * 32 + (swz % 64) / 2; }
__host__ __device__ __forceinline__ int perm32(int rho) { const int n = rho >> 4, i = rho & 15; return 8 * (i >> 2) + 4 * n + (i & 3); }

struct Unit { int pm, pn; };
struct Gemm { const bf16_t* A; const bf16_t* Bt; int M, N, K; };

struct StaticOrder {
    int nM, nN, nwg, G, c;
    __host__ __device__ void init(int M, int N, int G_, int c_) { nM = M / BM; nN = N / BM; nwg = nM * nN; G = G_; c = c_; }
    __host__ __device__ bool next(int i, Unit& u) const {
        const long L = (long)i * G + c; if (L >= nwg) return false;
        int wgid = (int)L; { const int q = nwg / NXCD, r = nwg % NXCD, xcd = wgid % NXCD, off = wgid / NXCD; wgid = (xcd < r ? xcd * (q + 1) : r * (q + 1) + (xcd - r) * q) + off; }
        const int nig = WGM * nN, gid = wgid / nig, fm = gid * WGM, gsz = (nM - fm) < WGM ? (nM - fm) : WGM;
        u.pm = fm + ((wgid % nig) % gsz); u.pn = (wgid % nig) / gsz; return true;
    }
    __device__ __forceinline__ void a_ready(const Unit&) const {}
    __device__ __forceinline__ void done(const Unit&) const {}
};

__device__ __forceinline__ unsigned cvt_pk_bf16(float lo, float hi) { unsigned r; asm volatile("v_cvt_pk_bf16_f32 %0, %1, %2" : "=v"(r) : "v"(lo), "v"(hi)); return r; }
typedef float f32x2 __attribute__((ext_vector_type(2)));
template <int ACT> struct EpiScale {
    static constexpr bool PERM = true, AFTER_DRAIN = false;
    bf16_t* O; int ldc; const float* ss; float invd, eps;
    __device__ __forceinline__ void operator()(const f32x4 (&acc)[2][2][4][2], const Unit& u, int wr, int wc, int fr, int fq) const {
        const int row0 = u.pm * BM + wr * 64 + fr, col0 = u.pn * BM + wc * 32 + 8 * fq;
#pragma unroll
        for (int ai = 0; ai < 2; ++ai)
#pragma unroll
            for (int m = 0; m < 4; ++m) { const int row = row0 + ai * HALF + m * 16; const float rs = __builtin_amdgcn_rsqf(ss[row] * invd + eps);
                bf16_t* rowp = O + (size_t)row * ldc + col0;
#pragma unroll
                for (int bj = 0; bj < 2; ++bj) { f32x4 v0 = acc[ai][bj][m][0] * rs, v1 = acc[ai][bj][m][1] * rs;
                    if (ACT == 2) {
#pragma unroll
                        for (int e = 0; e < 4; ++e) { const float a = fmaxf(v0[e], 0.f), b = fmaxf(v1[e], 0.f); v0[e] = a * a; v1[e] = b * b; } }
                    u32x4 w; w.x = cvt_pk_bf16(v0[0], v0[1]); w.y = cvt_pk_bf16(v0[2], v0[3]); w.z = cvt_pk_bf16(v1[0], v1[1]); w.w = cvt_pk_bf16(v1[2], v1[3]);
                    *(u32x4*)(rowp + bj * HALF) = w; } }
    }
};
struct EpiResid {
    static constexpr bool PERM = true, AFTER_DRAIN = false;
    const float* base; float* out; bf16_t* xb; float* ss; int ldc; int want_xb;
    __device__ __forceinline__ void operator()(const f32x4 (&acc)[2][2][4][2], const Unit& u, int wr, int wc, int fr, int fq) const {
        const int row0 = u.pm * BM + wr * 64 + fr, col0 = u.pn * BM + wc * 32 + 8 * fq;
#pragma unroll
        for (int ai = 0; ai < 2; ++ai)
#pragma unroll
            for (int m = 0; m < 4; ++m) { const int row = row0 + ai * HALF + m * 16; const size_t off = (size_t)row * ldc + col0; float q = 0.f;
#pragma unroll
                for (int bj = 0; bj < 2; ++bj) { const f32x4 b0 = *(const f32x4*)(base + off + bj * HALF), b1 = *(const f32x4*)(base + off + bj * HALF + 4);
                    const f32x4 v0 = acc[ai][bj][m][0] + b0, v1 = acc[ai][bj][m][1] + b1;
                    *(f32x4*)(out + off + bj * HALF) = v0; *(f32x4*)(out + off + bj * HALF + 4) = v1;
                    if (want_xb) { u32x4 w; w.x = cvt_pk_bf16(v0[0], v0[1]); w.y = cvt_pk_bf16(v0[2], v0[3]); w.z = cvt_pk_bf16(v1[0], v1[1]); w.w = cvt_pk_bf16(v1[2], v1[3]);
                        *(u32x4*)(xb + off + bj * HALF) = w;
                        q += (v0[0] * v0[0] + v0[1] * v0[1]) + (v0[2] * v0[2] + v0[3] * v0[3]) + (v1[0] * v1[0] + v1[1] * v1[1]) + (v1[2] * v1[2] + v1[3] * v1[3]); } }
                if (want_xb) { q += __shfl_xor(q, 16); q += __shfl_xor(q, 32);
                    if (fq == 0) __hip_atomic_fetch_add(ss + row, q, __ATOMIC_RELAXED, __HIP_MEMORY_SCOPE_AGENT); }
                asm volatile("" ::: "memory"); }
    }
};
template <class Epi, class Sched, bool ALIGN_EPI = false, bool SP2 = false>
__device__ __forceinline__ void gemm_phase(PG8_LAS unsigned char* lds, const Gemm g, const Sched& S, const Epi& E) {
    int tid_ = threadIdx.x; asm volatile("" : "+v"(tid_));
    const int tid = tid_, wid = __builtin_amdgcn_readfirstlane(tid >> 6), lane = tid & 63, wr = wid >> 2, wc = wid & 3, fr = lane & 15, fq = lane >> 4;
    const int K = g.K, nt = K / BK;
    unsigned voffA[2], voffB[2];
#pragma unroll
    for (int i = 0; i < 2; ++i) { int R, C; stage_rc(tid * 16 + i * 8192, R, C); const int Rb = Epi::PERM ? ((R & ~31) + perm32(R & 31)) : R;
        voffA[i] = (unsigned)(R * K + C) * 2u; voffB[i] = (unsigned)(Rb * K + C) * 2u; }
    const size_t kstep = (size_t)(BK * 2);
    const size_t hstep = (size_t)HALF * K * 2;
    const size_t tstep = 2 * hstep;
    const unsigned ldsw = (unsigned)wid * 1024u;
    const int aoff = lds_byte(wr * 64 + fr, fq * 8), boff = lds_byte(wc * 32 + fr, fq * 8);
#define PG8_SA(b, h) (((b) * 2 + (h)) * HTB)
#define PG8_SB(b, h) ((4 + (b) * 2 + (h)) * HTB)
#define PG8_STAGE(bufoff, gbase, voff) do { _Pragma("unroll") for (int _i = 0; _i < 2; ++_i) \
        __builtin_amdgcn_global_load_lds((const unsigned*)((const char*)(gbase) + (voff)[_i]), (PG8_LAS unsigned*)(lds + (bufoff) + ldsw + _i * 8192), 16, 0, 0); } while (0)
#define PG8_LDA(dst, b, h) do { _Pragma("unroll") for (int m = 0; m < 4; ++m) _Pragma("unroll") for (int k = 0; k < 2; ++k) dst[m][k] = *(const PG8_LAS bf16x8*)(lds + PG8_SA(b, h) + aoff + m * 2048 + k * 1024); } while (0)
#define PG8_LDB(dst, b, h) do { _Pragma("unroll") for (int n = 0; n < 2; ++n) _Pragma("unroll") for (int k = 0; k < 2; ++k) dst[n][k] = *(const PG8_LAS bf16x8*)(lds + PG8_SB(b, h) + boff + n * 2048 + k * 1024); } while (0)
#define PG8_MMA(ai, bj, At, Bt) do { __builtin_amdgcn_s_setprio(1); _Pragma("unroll") for (int m = 0; m < 4; ++m) _Pragma("unroll") for (int n = 0; n < 2; ++n) _Pragma("unroll") for (int k = 0; k < 2; ++k) \
        acc[ai][bj][m][n] = __builtin_amdgcn_mfma_f32_16x16x32_bf16(Bt[n][k], At[m][k], acc[ai][bj][m][n], 0, 0, 0); __builtin_amdgcn_s_setprio(0); } while (0)
#define PG8_WAIT_V(n) asm volatile("s_waitcnt vmcnt(" #n ")" ::: "memory")
#define PG8_WAIT_L(n) asm volatile("s_waitcnt lgkmcnt(" #n ")" ::: "memory")
#define PG8_BAR __builtin_amdgcn_s_barrier()
#define PG8_SCHED __builtin_amdgcn_sched_barrier(0)
    Unit cur, nxt; int ui = 0;
    if (!S.next(0, cur)) return;
    f32x4 acc[2][2][4][2];
#pragma unroll
    for (int a = 0; a < 2; ++a)
#pragma unroll
        for (int b = 0; b < 2; ++b)
#pragma unroll
            for (int m = 0; m < 4; ++m)
#pragma unroll
                for (int n = 0; n < 2; ++n) acc[a][b][m][n] = (f32x4){0.f, 0.f, 0.f, 0.f};
    bf16x8 At[4][2], B0[2][2], B1[2][2];
    const char* cA = (const char*)g.A + (size_t)cur.pm * tstep; const char* cB = (const char*)g.Bt + (size_t)cur.pn * tstep;
    S.a_ready(cur);
    if constexpr (SP2) {
        PG8_STAGE(PG8_SB(0, 0), cB, voffB); PG8_STAGE(PG8_SB(0, 1), cB + hstep, voffB); PG8_STAGE(PG8_SA(0, 0), cA, voffA); PG8_STAGE(PG8_SA(0, 1), cA + hstep, voffA);
        if (wr == 1) PG8_BAR;
        PG8_WAIT_V(2); PG8_BAR;
        PG8_STAGE(PG8_SB(1, 0), cB + kstep, voffB); PG8_STAGE(PG8_SA(1, 0), cA + kstep, voffA); PG8_STAGE(PG8_SB(1, 1), cB + hstep + kstep, voffB);
        PG8_WAIT_V(6); PG8_BAR;
    } else {
        PG8_STAGE(PG8_SB(0, 0), cB, voffB); PG8_STAGE(PG8_SA(0, 0), cA, voffA); PG8_STAGE(PG8_SB(0, 1), cB + hstep, voffB); PG8_STAGE(PG8_SA(0, 1), cA + hstep, voffA);
        if (wr == 1) PG8_BAR;
        PG8_WAIT_V(4); PG8_BAR;
        PG8_STAGE(PG8_SB(1, 0), cB + kstep, voffB); PG8_STAGE(PG8_SA(1, 0), cA + kstep, voffA); PG8_STAGE(PG8_SB(1, 1), cB + hstep + kstep, voffB);
        PG8_WAIT_V(6); PG8_BAR;
    }
    for (;;) {
        const bool has_next = S.next(ui + 1, nxt);
        const char* nA = has_next ? (const char*)g.A + (size_t)nxt.pm * tstep : cA; const char* nB = has_next ? (const char*)g.Bt + (size_t)nxt.pn * tstep : cB;
        for (int t = 0; t < nt; t += 2) {
            const bool last = (t == nt - 2);
            const char* a1 = cA + (size_t)(t + 1) * kstep;
            const char* a2 = last ? nA : cA + (size_t)(t + 2) * kstep; const char* b2 = last ? nB : cB + (size_t)(t + 2) * kstep;
            const char* a3 = a2 + kstep; const char* b3 = b2 + kstep;
            if (last && has_next) S.a_ready(nxt);
            if constexpr (SP2) {
            PG8_LDB(B0, 0, 0); PG8_LDB(B1, 0, 1); PG8_SCHED; PG8_LDA(At, 0, 0); PG8_STAGE(PG8_SA(1, 1), a1 + hstep, voffA);
            PG8_WAIT_V(8); PG8_WAIT_L(0); PG8_BAR; PG8_MMA(0, 0, At, B0); PG8_MMA(0, 1, At, B1); PG8_BAR; PG8_SCHED;
            PG8_LDA(At, 0, 1); PG8_STAGE(PG8_SB(0, 0), b2, voffB); PG8_STAGE(PG8_SB(0, 1), b2 + hstep, voffB); PG8_STAGE(PG8_SA(0, 0), a2, voffA);
            PG8_WAIT_V(8); PG8_WAIT_L(0); PG8_BAR; PG8_MMA(1, 0, At, B0); PG8_MMA(1, 1, At, B1); PG8_BAR; PG8_SCHED;
            PG8_LDB(B0, 1, 0); PG8_LDB(B1, 1, 1); PG8_SCHED; PG8_LDA(At, 1, 0); PG8_STAGE(PG8_SA(0, 1), a2 + hstep, voffA);
            PG8_WAIT_V(8); PG8_WAIT_L(0); PG8_BAR; PG8_MMA(0, 0, At, B0); PG8_MMA(0, 1, At, B1); PG8_BAR; PG8_SCHED;
            PG8_LDA(At, 1, 1); PG8_STAGE(PG8_SB(1, 0), b3, voffB); PG8_STAGE(PG8_SB(1, 1), b3 + hstep, voffB); PG8_STAGE(PG8_SA(1, 0), a3, voffA);
            PG8_WAIT_V(8); PG8_WAIT_L(0); PG8_BAR; PG8_MMA(1, 0, At, B0); PG8_MMA(1, 1, At, B1); PG8_BAR; PG8_SCHED;
            } else {
            PG8_LDB(B0, 0, 0); PG8_SCHED; PG8_LDA(At, 0, 0); PG8_STAGE(PG8_SA(1, 1), a1 + hstep, voffA);
            PG8_WAIT_L(8); PG8_BAR; PG8_WAIT_L(0); PG8_MMA(0, 0, At, B0); PG8_BAR; PG8_SCHED;
            PG8_LDB(B1, 0, 1); PG8_STAGE(PG8_SB(0, 0), b2, voffB);
            PG8_BAR; PG8_WAIT_L(0); PG8_MMA(0, 1, At, B1); PG8_BAR;
            PG8_LDA(At, 0, 1); PG8_STAGE(PG8_SA(0, 0), a2, voffA);
            PG8_BAR; PG8_WAIT_L(0); PG8_MMA(1, 0, At, B0); PG8_BAR; PG8_SCHED;
            PG8_STAGE(PG8_SB(0, 1), b2 + hstep, voffB);
            PG8_WAIT_V(6); PG8_BAR; PG8_MMA(1, 1, At, B1); PG8_BAR;
            PG8_LDB(B0, 1, 0); PG8_SCHED; PG8_LDA(At, 1, 0); PG8_STAGE(PG8_SA(0, 1), a2 + hstep, voffA);
            PG8_WAIT_L(8); PG8_BAR; PG8_WAIT_L(0); PG8_MMA(0, 0, At, B0); PG8_BAR; PG8_SCHED;
            PG8_LDB(B1, 1, 1); PG8_STAGE(PG8_SB(1, 0), b3, voffB);
            PG8_BAR; PG8_WAIT_L(0); PG8_MMA(0, 1, At, B1); PG8_BAR;
            PG8_LDA(At, 1, 1); PG8_STAGE(PG8_SA(1, 0), a3, voffA);
            PG8_BAR; PG8_WAIT_L(0); PG8_MMA(1, 0, At, B0); PG8_BAR; PG8_SCHED;
            PG8_STAGE(PG8_SB(1, 1), b3 + hstep, voffB);
            PG8_WAIT_V(6); PG8_BAR; PG8_MMA(1, 1, At, B1); PG8_BAR;
            }
        }
        if constexpr (ALIGN_EPI) { if (wr == 0) PG8_BAR; }
        if constexpr (!Epi::AFTER_DRAIN) { E(acc, cur, wr, wc, fr, fq); S.done(cur); }
        if (!has_next) break;
#pragma unroll
        for (int a = 0; a < 2; ++a)
#pragma unroll
            for (int b = 0; b < 2; ++b)
#pragma unroll
                for (int m = 0; m < 4; ++m)
#pragma unroll
                    for (int n = 0; n < 2; ++n) acc[a][b][m][n] = (f32x4){0.f, 0.f, 0.f, 0.f};
        cur = nxt; cA = nA; cB = nB; ++ui;
        if constexpr (ALIGN_EPI) { if (wr == 1) PG8_BAR; }
    }
    PG8_WAIT_V(0);
    if constexpr (!ALIGN_EPI) { if (wr == 0) PG8_BAR; }
    PG8_BAR;
    if constexpr (Epi::AFTER_DRAIN) { E.fused(acc, cur, wr, wc, fr, fq, lds, wid, lane); S.done(cur); }
#undef PG8_SA
#undef PG8_SB
#undef PG8_STAGE
#undef PG8_LDA
#undef PG8_LDB
#undef PG8_MMA
#undef PG8_WAIT_V
#undef PG8_WAIT_L
#undef PG8_BAR
#undef PG8_SCHED
}
}
constexpr int NWAVES = 8, NTHREADS = 512;
constexpr int BATCH = 2, SEQ = 4096, M = BATCH * SEQ, D = 2048, NPROJ = 5632, FF = 8192, DEPTH = 2, HD = 64;
constexpr int COL_AU = 0, COL_AV = 512, COL_BB = 1024, COL_BC = 1792, COL_BX = 2560, COL_Q = 3328, COL_K = 4096, COL_V = 4864;
constexpr int YC_A = 0, YC_B = 512, YC_C = 1280;
constexpr int NCH = 12;
constexpr float EPS = 1e-6f;
constexpr size_t MiB = 1u << 20;
constexpr size_t WS_SS = 0;
constexpr size_t WS_LSE = 1 * MiB;
constexpr size_t WS_WIN = 2 * MiB, WIN_L = (size_t)NPROJ * D * 2;
constexpr size_t WS_WOUT = WS_WIN + DEPTH * WIN_L, WOUT_L = (size_t)D * D * 2;
constexpr size_t WS_W1 = WS_WOUT + DEPTH * WOUT_L, W1_L = (size_t)FF * D * 2;
constexpr size_t WS_W2 = WS_W1 + DEPTH * W1_L, W2_L = (size_t)D * FF * 2;
constexpr size_t WS_XB = WS_W2 + DEPTH * W2_L;
constexpr size_t WS_Y = WS_XB + (size_t)M * D * 2;
constexpr size_t WS_P = WS_Y + (size_t)M * D * 2;
constexpr size_t WS_END = WS_P + (size_t)M * FF * 2;
constexpr int LDS_BYTES = 147456;

#define LAS __attribute__((address_space(3)))
typedef unsigned short bf16;
typedef unsigned u32x4v __attribute__((ext_vector_type(4)));
typedef unsigned u32x2v __attribute__((ext_vector_type(2)));
typedef float f32x4 __attribute__((ext_vector_type(4)));
typedef short bf16x8 __attribute__((ext_vector_type(8)));
typedef short s16x4 __attribute__((ext_vector_type(4)));
using pg8::cvt_pk_bf16;
__device__ __forceinline__ float bflo(unsigned u) { return __uint_as_float(u << 16); }
__device__ __forceinline__ float bfhi(unsigned u) { return __uint_as_float(u & 0xffff0000u); }
__device__ __forceinline__ float wave_sum(float v) {
#pragma unroll
    for (int o = 1; o < 64; o <<= 1) v += __shfl_xor(v, o);
    return v;
}
#define LDS_WAIT() asm volatile("s_waitcnt lgkmcnt(0)" ::: "memory")

__device__ __forceinline__ void p0_transpose_item(const float* W, const float* gain, int K, int N, bf16* WT, LAS float* scr, int item, int lane) {
    const int nblk = N / 32, kb = item / nblk, nb = item % nblk, k0 = 64 * kb, n0 = 32 * nb;
#pragma unroll 8
    for (int i = 0; i < 32; ++i) { const int kk = 2 * i + (lane >> 5); float v = W[(size_t)(k0 + kk) * N + n0 + (lane & 31)]; if (gain) v *= gain[k0 + kk]; scr[kk * 33 + (lane & 31)] = v; }
    LDS_WAIT(); asm volatile("" ::: "memory");
    const int c = lane & 7;
#pragma unroll
    for (int j = 0; j < 4; ++j) { const int n = (lane >> 3) + 8 * j; const LAS float* s = scr + (8 * c) * 33 + n;
        u32x4v o; o.x = cvt_pk_bf16(s[0 * 33], s[1 * 33]); o.y = cvt_pk_bf16(s[2 * 33], s[3 * 33]); o.z = cvt_pk_bf16(s[4 * 33], s[5 * 33]); o.w = cvt_pk_bf16(s[6 * 33], s[7 * 33]);
        *(u32x4v*)(WT + (size_t)(n0 + n) * K + k0 + 8 * c) = o; }
    LDS_WAIT(); asm volatile("" ::: "memory");
}

struct Args { const float* in[12]; float* out; unsigned char* ws; };

__device__ __forceinline__ void p0_prologue(const Args& a, LAS unsigned char* lds, int tid, int lane, int wave) {
    LAS float* scr = (LAS float*)(lds + wave * 16384);
    const int gw = blockIdx.x * NWAVES + wave, NGW = gridDim.x * NWAVES;
    constexpr int I_IN = (D / 64) * (NPROJ / 32), I_OUT = (D / 64) * (D / 32), I_1 = (D / 64) * (FF / 32), I_2 = (FF / 64) * (D / 32), I_L = I_IN + I_OUT + I_1 + I_2;
    unsigned char* ws = a.ws;
    for (int it = gw; it < DEPTH * I_L; it += NGW) {
        const int l = it / I_L; int r = it % I_L;
        if (r < I_IN) { p0_transpose_item(a.in[2] + (size_t)l * D * NPROJ, a.in[1] + l * D, D, NPROJ, (bf16*)(ws + WS_WIN + l * WIN_L), scr, r, lane); continue; } r -= I_IN;
        if (r < I_OUT) { p0_transpose_item(a.in[8] + (size_t)l * D * D, nullptr, D, D, (bf16*)(ws + WS_WOUT + l * WOUT_L), scr, r, lane); continue; } r -= I_OUT;
        if (r < I_1) { p0_transpose_item(a.in[10] + (size_t)l * D * FF, a.in[9] + l * D, D, FF, (bf16*)(ws + WS_W1 + l * W1_L), scr, r, lane); continue; } r -= I_1;
        p0_transpose_item(a.in[11] + (size_t)l * FF * D, nullptr, FF, D, (bf16*)(ws + WS_W2 + l * W2_L), scr, r, lane);
    }
    float* ss = (float*)(ws + WS_SS); bf16* xb = (bf16*)(ws + WS_XB);
    for (int m = gw; m < M; m += NGW) {
        const f32x4* xr = (const f32x4*)(a.in[0] + (size_t)m * D) + lane; float s = 0.f;
        unsigned long long* o8 = (unsigned long long*)(xb + (size_t)m * D) + lane;
#pragma unroll
        for (int j = 0; j < 8; ++j) { const f32x4 v = xr[64 * j]; s += (v.x * v.x + v.y * v.y) + (v.z * v.z + v.w * v.w);
            o8[64 * j] = (unsigned long long)cvt_pk_bf16(v.x, v.y) | ((unsigned long long)cvt_pk_bf16(v.z, v.w) << 32); }
        s = wave_sum(s); if (lane == 0) ss[m] = s;
    }
    for (int i = blockIdx.x * NTHREADS + tid; i < 4 * M; i += gridDim.x * NTHREADS) ss[M + i] = 0.f;
}

constexpr int KS_STRIDE = 144;
constexpr int VT_STRIDE = 528;
constexpr int KS_OFF = 0, VT_OFF = 256 * KS_STRIDE;
static_assert(VT_OFF + 64 * VT_STRIDE <= 131072, "mix lds");

__device__ __forceinline__ void attn_unit(const bf16* P, bf16* Y, float* LSE, const float* qg, const float* kg, LAS unsigned char* lds,
                                          int b, int h, int dil, int r, int n, int tid, int lane, int wave) {
    const int fr = lane & 15, fq = lane >> 4;
    __syncthreads();
    {
        const int kk = tid >> 1, half = tid & 1; const int j = (n - 1) * 128 + kk; const bool valid = j >= 0;
        const size_t row = (size_t)b * SEQ + (size_t)(valid ? j : 0) * dil + r;
        const u32x4v* kp = (const u32x4v*)(P + row * NPROJ + COL_K + h * HD + half * 32);
        const u32x4v* vp = (const u32x4v*)(P + row * NPROJ + COL_V + h * HD + half * 32);
        u32x4v kq[4], vq[4];
#pragma unroll
        for (int i = 0; i < 4; ++i) { kq[i] = kp[i]; vq[i] = vp[i]; }
        float s = 0.f;
#pragma unroll
        for (int i = 0; i < 4; ++i)
#pragma unroll
            for (int e = 0; e < 4; ++e) { const float lo = bflo(kq[i][e]), hi = bfhi(kq[i][e]); s += lo * lo + hi * hi; }
        s += __shfl_xor(s, 1);
        const float rs = valid ? __builtin_amdgcn_rsqf(s * (1.f / HD) + EPS) : 0.f;
        const f32x4* g4 = (const f32x4*)(kg + half * 32);
        LAS u32x4v* kd = (LAS u32x4v*)(lds + KS_OFF + kk * KS_STRIDE + half * 64);
#pragma unroll
        for (int i = 0; i < 4; ++i) { const f32x4 ga = g4[2 * i], gb = g4[2 * i + 1]; u32x4v w;
            w.x = cvt_pk_bf16(bflo(kq[i].x) * rs * ga.x, bfhi(kq[i].x) * rs * ga.y); w.y = cvt_pk_bf16(bflo(kq[i].y) * rs * ga.z, bfhi(kq[i].y) * rs * ga.w);
            w.z = cvt_pk_bf16(bflo(kq[i].z) * rs * gb.x, bfhi(kq[i].z) * rs * gb.y); w.w = cvt_pk_bf16(bflo(kq[i].w) * rs * gb.z, bfhi(kq[i].w) * rs * gb.w);
            kd[i] = w; }
        LAS unsigned short* vt = (LAS unsigned short*)(lds + VT_OFF) + kk;
#pragma unroll
        for (int i = 0; i < 4; ++i)
#pragma unroll
            for (int e = 0; e < 4; ++e) { const unsigned u = valid ? vq[i][e] : 0u; const int dd = half * 32 + i * 8 + e * 2;
                vt[(dd) * (VT_STRIDE / 2)] = (unsigned short)(u & 0xffffu); vt[(dd + 1) * (VT_STRIDE / 2)] = (unsigned short)(u >> 16); }
    }
    const int qi = 16 * wave + fr; const size_t qrow = (size_t)b * SEQ + (size_t)(n * 128 + qi) * dil + r;
    bf16x8 qf[2];
    {
        u32x4v q0 = *(const u32x4v*)(P + qrow * NPROJ + COL_Q + h * HD + fq * 8), q1 = *(const u32x4v*)(P + qrow * NPROJ + COL_Q + h * HD + 32 + fq * 8);
        float s = 0.f;
#pragma unroll
        for (int e = 0; e < 4; ++e) { const float a = bflo(q0[e]), c = bfhi(q0[e]), d2 = bflo(q1[e]), f = bfhi(q1[e]); s += (a * a + c * c) + (d2 * d2 + f * f); }
        s += __shfl_xor(s, 16); s += __shfl_xor(s, 32);
        const float rs = __builtin_amdgcn_rsqf(s * (1.f / HD) + EPS) * (0.125f * 1.4426950408889634f);
        const f32x4* g0 = (const f32x4*)(qg + fq * 8); const f32x4* g1 = (const f32x4*)(qg + 32 + fq * 8);
        const f32x4 ga = g0[0], gb = g0[1], gc = g1[0], gd = g1[1];
        u32x4v w0, w1;
        w0.x = cvt_pk_bf16(bflo(q0.x) * rs * ga.x, bfhi(q0.x) * rs * ga.y); w0.y = cvt_pk_bf16(bflo(q0.y) * rs * ga.z, bfhi(q0.y) * rs * ga.w);
        w0.z = cvt_pk_bf16(bflo(q0.z) * rs * gb.x, bfhi(q0.z) * rs * gb.y); w0.w = cvt_pk_bf16(bflo(q0.w) * rs * gb.z, bfhi(q0.w) * rs * gb.w);
        w1.x = cvt_pk_bf16(bflo(q1.x) * rs * gc.x, bfhi(q1.x) * rs * gc.y); w1.y = cvt_pk_bf16(bflo(q1.y) * rs * gc.z, bfhi(q1.y) * rs * gc.w);
        w1.z = cvt_pk_bf16(bflo(q1.z) * rs * gd.x, bfhi(q1.z) * rs * gd.y); w1.w = cvt_pk_bf16(bflo(q1.w) * rs * gd.z, bfhi(q1.w) * rs * gd.w);
        qf[0] = __builtin_bit_cast(bf16x8, w0); qf[1] = __builtin_bit_cast(bf16x8, w1);
    }
    __syncthreads();
    const int tile0 = 2 * (wave >> 1);
    const LAS unsigned char* kbase = lds + KS_OFF + (tile0 * 16 + fr) * KS_STRIDE + fq * 16;
    const LAS unsigned char* vbase = lds + VT_OFF + fr * VT_STRIDE + (tile0 * 16 + 4 * fq) * 2;
    f32x4 sa[10];
#pragma unroll
    for (int tt = 0; tt < 10; ++tt) { sa[tt] = (f32x4){0.f, 0.f, 0.f, 0.f};
#pragma unroll
        for (int ks = 0; ks < 2; ++ks) { const bf16x8 kf = *(const LAS bf16x8*)(kbase + tt * 16 * KS_STRIDE + ks * 64);
            sa[tt] = __builtin_amdgcn_mfma_f32_16x16x32_bf16(kf, qf[ks], sa[tt], 0, 0, 0); } }
    float mx = -1e30f;
#pragma unroll
    for (int tt = 0; tt < 10; ++tt)
#pragma unroll
        for (int i = 0; i < 4; ++i) { const int kj = (tile0 + tt) * 16 + 4 * fq + i; const bool ok = (kj >= qi) && (kj <= qi + 128) && (n > 0 || kj >= 128);
            const float v = ok ? sa[tt][i] : -1e30f; sa[tt][i] = v; mx = fmaxf(mx, v); }
    mx = fmaxf(mx, __shfl_xor(mx, 16)); mx = fmaxf(mx, __shfl_xor(mx, 32));
    float den = 0.f;
#pragma unroll
    for (int tt = 0; tt < 10; ++tt)
#pragma unroll
        for (int i = 0; i < 4; ++i) { const float p = __builtin_amdgcn_exp2f(sa[tt][i] - mx); sa[tt][i] = p; den += p; }
    den += __shfl_xor(den, 16); den += __shfl_xor(den, 32);
    f32x4 oa[4];
#pragma unroll
    for (int dt = 0; dt < 4; ++dt) oa[dt] = (f32x4){0.f, 0.f, 0.f, 0.f};
#pragma unroll
    for (int k5 = 0; k5 < 5; ++k5) {
        u32x4v pw; pw.x = cvt_pk_bf16(sa[2 * k5][0], sa[2 * k5][1]); pw.y = cvt_pk_bf16(sa[2 * k5][2], sa[2 * k5][3]);
        pw.z = cvt_pk_bf16(sa[2 * k5 + 1][0], sa[2 * k5 + 1][1]); pw.w = cvt_pk_bf16(sa[2 * k5 + 1][2], sa[2 * k5 + 1][3]);
        const bf16x8 pf = __builtin_bit_cast(bf16x8, pw);
#pragma unroll
        for (int dt = 0; dt < 4; ++dt) { const LAS unsigned char* vr = vbase + dt * 16 * VT_STRIDE + k5 * 64;
            const u32x2v a0 = *(const LAS u32x2v*)vr, a1 = *(const LAS u32x2v*)(vr + 32);
            u32x4v vw; vw.x = a0.x; vw.y = a0.y; vw.z = a1.x; vw.w = a1.y;
            oa[dt] = __builtin_amdgcn_mfma_f32_16x16x32_bf16(__builtin_bit_cast(bf16x8, vw), pf, oa[dt], 0, 0, 0); }
    }
    const float inv = 1.f / den;
    bf16* yo = Y + qrow * D + YC_C + h * HD + 4 * fq;
#pragma unroll
    for (int dt = 0; dt < 4; ++dt) { u32x2v w; w.x = cvt_pk_bf16(oa[dt][0] * inv, oa[dt][1] * inv); w.y = cvt_pk_bf16(oa[dt][2] * inv, oa[dt][3] * inv); *(u32x2v*)(yo + dt * 16) = w; }
    if (fq == 0) LSE[qrow * NCH + h] = (mx + __builtin_amdgcn_logf(den)) * 0.6931471805599453f;
}

__device__ __forceinline__ void sgu_unit(const bf16* P, bf16* Y, const float* Ws  , const float* bs  , LAS unsigned char* lds,
                                         int b, int c, int h, int tid, int lane, int wave) {
    const int fr = lane & 15, fq = lane >> 4;
    __syncthreads();
    {
        const int j = tid >> 2, qd = tid & 3; const size_t row = (size_t)b * SEQ + c * 128 + j;
        const u32x4v* vp = (const u32x4v*)(P + row * NPROJ + COL_AV + h * HD + qd * 16);
        const u32x4v v0 = vp[0], v1 = vp[1];
        LAS unsigned short* vt = (LAS unsigned short*)(lds + VT_OFF) + j;
#pragma unroll
        for (int e = 0; e < 4; ++e) { const int dd = qd * 16 + e * 2; vt[dd * (VT_STRIDE / 2)] = (unsigned short)(v0[e] & 0xffffu); vt[(dd + 1) * (VT_STRIDE / 2)] = (unsigned short)(v0[e] >> 16);
            vt[(dd + 8) * (VT_STRIDE / 2)] = (unsigned short)(v1[e] & 0xffffu); vt[(dd + 9) * (VT_STRIDE / 2)] = (unsigned short)(v1[e] >> 16); }
    }
    __syncthreads();
    const int i = 16 * wave + fr; const size_t row = (size_t)b * SEQ + c * 128 + i;
    f32x4 acc[4];
#pragma unroll
    for (int dt = 0; dt < 4; ++dt) acc[dt] = (f32x4){0.f, 0.f, 0.f, 0.f};
    const float* wrow = Ws + ((size_t)h * 128 + i) * 128 + 8 * fq;
    const int njs = (__builtin_amdgcn_readfirstlane(wave) >> 1) + 1;
    const LAS unsigned char* svbase = lds + VT_OFF + fr * VT_STRIDE + fq * 16;
    for (int js = 0; js < njs; ++js) {
        const f32x4 w0 = *(const f32x4*)(wrow + 32 * js), w1 = *(const f32x4*)(wrow + 32 * js + 4);
        const int j0 = 32 * js + 8 * fq;
        u32x4v ww;
        ww.x = cvt_pk_bf16(j0 + 0 <= i ? w0.x : 0.f, j0 + 1 <= i ? w0.y : 0.f); ww.y = cvt_pk_bf16(j0 + 2 <= i ? w0.z : 0.f, j0 + 3 <= i ? w0.w : 0.f);
        ww.z = cvt_pk_bf16(j0 + 4 <= i ? w1.x : 0.f, j0 + 5 <= i ? w1.y : 0.f); ww.w = cvt_pk_bf16(j0 + 6 <= i ? w1.z : 0.f, j0 + 7 <= i ? w1.w : 0.f);
        const bf16x8 wf = __builtin_bit_cast(bf16x8, ww);
#pragma unroll
        for (int dt = 0; dt < 4; ++dt) { const bf16x8 vf = *(const LAS bf16x8*)(svbase + dt * 16 * VT_STRIDE + js * 64);
            acc[dt] = __builtin_amdgcn_mfma_f32_16x16x32_bf16(vf, wf, acc[dt], 0, 0, 0); }
    }
    const float bias = bs[h * 128 + i];
    const bf16* up = P + row * NPROJ + COL_AU + h * HD + 4 * fq; bf16* yo = Y + row * D + YC_A + h * HD + 4 * fq;
#pragma unroll
    for (int dt = 0; dt < 4; ++dt) { const u32x2v uu = *(const u32x2v*)(up + dt * 16); u32x2v w;
        w.x = cvt_pk_bf16(bflo(uu.x) * (acc[dt][0] + bias), bfhi(uu.x) * (acc[dt][1] + bias)); w.y = cvt_pk_bf16(bflo(uu.y) * (acc[dt][2] + bias), bfhi(uu.y) * (acc[dt][3] + bias));
        *(u32x2v*)(yo + dt * 16) = w; }
}

__device__ __forceinline__ void mix2_phase(const bf16* P, bf16* Y, const float* LSE, const float* cw  , int tid) {
    const int total = M * 192;
    for (int it = blockIdx.x * NTHREADS + tid; it < total; it += gridDim.x * NTHREADS) {
        const int row = it / 192, c = it % 192;
        if (c < 96) {
            const int ch = c * 8, t = row % SEQ; const bf16* pr = P + (size_t)row * NPROJ;
            const u32x4v bg = *(const u32x4v*)(pr + COL_BB + ch);
            u32x4v cg0 = *(const u32x4v*)(pr + COL_BC + ch), xg0 = *(const u32x4v*)(pr + COL_BX + ch);
            u32x4v cg1 = (u32x4v){0, 0, 0, 0}, xg1 = cg1, cg2 = cg1, xg2 = cg1;
            if (t >= 1) { cg1 = *(const u32x4v*)(pr - NPROJ + COL_BC + ch); xg1 = *(const u32x4v*)(pr - NPROJ + COL_BX + ch); }
            if (t >= 2) { cg2 = *(const u32x4v*)(pr - 2 * NPROJ + COL_BC + ch); xg2 = *(const u32x4v*)(pr - 2 * NPROJ + COL_BX + ch); }
            const f32x4 wa0 = *(const f32x4*)(cw + ch), wa1 = *(const f32x4*)(cw + ch + 4), wb0 = *(const f32x4*)(cw + 768 + ch), wb1 = *(const f32x4*)(cw + 768 + ch + 4),
                        wc0 = *(const f32x4*)(cw + 1536 + ch), wc1 = *(const f32x4*)(cw + 1536 + ch + 4);
            u32x4v o;
#pragma unroll
            for (int e = 0; e < 4; ++e) {
                const float w0l = e < 2 ? wa0[2 * e] : wa1[2 * e - 4], w0h = e < 2 ? wa0[2 * e + 1] : wa1[2 * e - 3];
                const float w1l = e < 2 ? wb0[2 * e] : wb1[2 * e - 4], w1h = e < 2 ? wb0[2 * e + 1] : wb1[2 * e - 3];
                const float w2l = e < 2 ? wc0[2 * e] : wc1[2 * e - 4], w2h = e < 2 ? wc0[2 * e + 1] : wc1[2 * e - 3];
                const float lo = bflo(bg[e]) * (w0l * bflo(cg2[e]) * bflo(xg2[e]) + w1l * bflo(cg1[e]) * bflo(xg1[e]) + w2l * bflo(cg0[e]) * bflo(xg0[e]));
                const float hi = bfhi(bg[e]) * (w0h * bfhi(cg2[e]) * bfhi(xg2[e]) + w1h * bfhi(cg1[e]) * bfhi(xg1[e]) + w2h * bfhi(cg0[e]) * bfhi(xg0[e]));
                o[e] = cvt_pk_bf16(lo, hi); }
            *(u32x4v*)(Y + (size_t)row * D + YC_B + ch) = o;
        } else {
            const int cc = c - 96, hh = cc >> 3, g = hh >> 2, hs = hh & 3;
            const float* lp = LSE + (size_t)row * NCH + hs; const float l0 = lp[0], l1 = lp[4], l2 = lp[8];
            const float mx = fmaxf(l0, fmaxf(l1, l2)); const float e0 = __expf(l0 - mx), e1 = __expf(l1 - mx), e2 = __expf(l2 - mx);
            const float al = (g == 0 ? e0 : (g == 1 ? e1 : e2)) / (e0 + e1 + e2);
            bf16* yp = Y + (size_t)row * D + YC_C + cc * 8; u32x4v v = *(const u32x4v*)yp;
#pragma unroll
            for (int e = 0; e < 4; ++e) v[e] = cvt_pk_bf16(bflo(v[e]) * al, bfhi(v[e]) * al);
            *(u32x4v*)yp = v;
        }
    }
}

__global__ void __launch_bounds__(NTHREADS, 2) mk_fwd(Args args) {
    extern __shared__ __attribute__((aligned(16))) unsigned char lds_raw[];
    LAS unsigned char* lds = (LAS unsigned char*)lds_raw;
    cg::grid_group grid = cg::this_grid();
    const int tid = threadIdx.x, lane = tid & 63, wave = __builtin_amdgcn_readfirstlane(tid >> 6);
    const int G = gridDim.x;
    unsigned char* ws = args.ws;
    float* ss = (float*)(ws + WS_SS); float* LSE = (float*)(ws + WS_LSE);
    bf16* XB = (bf16*)(ws + WS_XB); bf16* Y = (bf16*)(ws + WS_Y); bf16* P = (bf16*)(ws + WS_P); bf16* H = (bf16*)(ws + WS_P);

    p0_prologue(args, lds, tid, lane, wave);
    grid.sync();

#pragma nounroll
    for (int l = 0; l < DEPTH; ++l) {
        {
            pg8::Gemm g{XB, (const bf16*)(ws + WS_WIN + l * WIN_L), M, NPROJ, D}; pg8::StaticOrder S; S.init(M, NPROJ, G, (int)blockIdx.x);
            pg8::EpiScale<0> E{P, NPROJ, ss + (2 * l) * M, 1.f / D, EPS};
            pg8::gemm_phase<pg8::EpiScale<0>, pg8::StaticOrder, true, true>(lds, g, S, E);
        }
        grid.sync();
        {
            const float* qg = args.in[6] + l * HD; const float* kg = args.in[7] + l * HD;
            const float* Wsl = args.in[3] + (size_t)l * 8 * 128 * 128; const float* bsl = args.in[4] + l * 8 * 128;
            int tidv = threadIdx.x; asm volatile("" : "+v"(tidv)); const int lanev = tidv & 63, wavev = tidv >> 6;
            for (int it = blockIdx.x; it < 768 + 512; it += G) {
                if (it < 768) { const int b = it / 384, rem = it % 384, h = rem >> 5, u = rem & 31; const int gp = h >> 2; const int dil = gp == 0 ? 1 : (gp == 1 ? 4 : 16); const int nb = 32 / dil;
                    attn_unit(P, Y, LSE, qg, kg, lds, b, h, dil, u / nb, u % nb, tidv, lanev, wavev); }
                else { const int s = it - 768; const int b = s >> 8, rem = s & 255, c = rem >> 3, h = rem & 7; sgu_unit(P, Y, Wsl, bsl, lds, b, c, h, tidv, lanev, wavev); }
            }
        }
        grid.sync();
        mix2_phase(P, Y, LSE, args.in[5] + (size_t)l * 3 * 768, tid);
        grid.sync();
        {
            pg8::Gemm g{Y, (const bf16*)(ws + WS_WOUT + l * WOUT_L), M, D, D}; pg8::StaticOrder S; S.init(M, D, G, (int)blockIdx.x);
            pg8::EpiResid E{l == 0 ? args.in[0] : (const float*)args.out, args.out, XB, ss + (2 * l + 1) * M, D, 1};
            pg8::gemm_phase<pg8::EpiResid, pg8::StaticOrder, true, true>(lds, g, S, E);
        }
        grid.sync();
        {
            pg8::Gemm g{XB, (const bf16*)(ws + WS_W1 + l * W1_L), M, FF, D}; pg8::StaticOrder S; S.init(M, FF, G, (int)blockIdx.x);
            pg8::EpiScale<2> E{H, FF, ss + (2 * l + 1) * M, 1.f / D, EPS};
            pg8::gemm_phase<pg8::EpiScale<2>, pg8::StaticOrder, true, true>(lds, g, S, E);
        }
        grid.sync();
        {
            pg8::Gemm g{H, (const bf16*)(ws + WS_W2 + l * W2_L), M, D, FF}; pg8::StaticOrder S; S.init(M, D, G, (int)blockIdx.x);
            pg8::EpiResid E{(const float*)args.out, args.out, XB, ss + (2 * l + 2) * M, D, l + 1 < DEPTH ? 1 : 0};
            pg8::gemm_phase<pg8::EpiResid, pg8::StaticOrder, true, true>(lds, g, S, E);
        }
        if (l + 1 < DEPTH) grid.sync();
    }
}

extern "C" void kernel_launch(void* const* d_in, const int* in_sizes, int n_in, void* d_out, int out_size, void* d_ws, size_t ws_size, hipStream_t stream) {
    static int grid = 0;
    if (grid == 0) {
        if (n_in != 12 || in_sizes[0] != M * D || out_size != M * D || ws_size < WS_END) { fprintf(stderr, "kernel_launch: unexpected shapes (n_in %d, in0 %d, out %d, ws %zu < %zu)\n", n_in, n_in > 0 ? in_sizes[0] : -1, out_size, ws_size, (size_t)WS_END); grid = -1; return; }
        int dev = 0, cus = 0, per_cu = 0;
        if (hipGetDevice(&dev) != hipSuccess || hipDeviceGetAttribute(&cus, hipDeviceAttributeMultiprocessorCount, dev) != hipSuccess) { grid = -1; return; }
        if (hipFuncSetAttribute((const void*)mk_fwd, hipFuncAttributeMaxDynamicSharedMemorySize, LDS_BYTES) != hipSuccess) { fprintf(stderr, "kernel_launch: hipFuncSetAttribute failed\n"); grid = -1; return; }
        if (hipOccupancyMaxActiveBlocksPerMultiprocessor(&per_cu, (const void*)mk_fwd, NTHREADS, LDS_BYTES) != hipSuccess || per_cu < 1) { fprintf(stderr, "kernel_launch: occupancy query says %d blocks per CU\n", per_cu); (void)hipGetLastError(); grid = -1; return; }
        grid = cus;
    }
    if (grid < 0) return;
    Args a{};
    for (int i = 0; i < 12; ++i) a.in[i] = (const float*)d_in[i];
    a.out = (float*)d_out; a.ws = (unsigned char*)d_ws;
    void* kargs[] = {&a};
    hipError_t e = hipLaunchCooperativeKernel((const void*)mk_fwd, dim3(grid), dim3(NTHREADS), kargs, LDS_BYTES, stream);
    if (e != hipSuccess) fprintf(stderr, "kernel_launch: cooperative launch failed: %s (grid %d)\n", hipGetErrorString(e), grid);
}
```
